# Optimizing an MI355X kernel written in HIP

```python
import math
import jax, jax.numpy as jnp
from jax import lax
import numpy as np

D_MODEL = 2048
BATCH = 16
SEQ = 2048
DEPTH = 1

EPS = 1e-5
D_CONV_MIX = D_MODEL // 2
CONV_A_WIDTH = 3
D_SSD = D_MODEL // 2
SSD_HEAD_DIM = 64
SSD_HEADS = D_SSD // SSD_HEAD_DIM
SSD_GROUPS = 4
HEADS_PER_GROUP = SSD_HEADS // SSD_GROUPS
SSD_STATE = 128
SSD_CONV_WIDTH = 5
SSD_CHUNK = 128
D_XBC = D_SSD + 2 * SSD_GROUPS * SSD_STATE
D_MIX = D_CONV_MIX + D_SSD
COL_SPLITS = (
    D_CONV_MIX,
    2 * D_CONV_MIX,
    3 * D_CONV_MIX,
    3 * D_CONV_MIX + D_SSD,
    3 * D_CONV_MIX + D_SSD + D_XBC,
)
IN_COLS = 3 * D_CONV_MIX + D_SSD + D_XBC + 2 * SSD_HEADS
N_EXPERTS = 32
TOP_K = 4
D_FF = D_MODEL
SWIGLU_LIMIT = 7.0
SWIGLU_ALPHA = 1.702
MOE_BLOCK = 128

kernel_name = "hybrid_conv_ssd_moe_encoder"


def rms_norm(x, w):
    xf = x.astype(jnp.float32)
    y = xf * lax.rsqrt(jnp.mean(xf * xf, axis=-1, keepdims=True) + EPS)
    return (y * w.astype(jnp.float32)).astype(x.dtype)


def depthwise_conv(u, w):
    return lax.conv_general_dilated(
        u, w.astype(u.dtype)[:, None, :], window_strides=(1,), padding="SAME",
        dimension_numbers=("NWC", "WIO", "NWC"), feature_group_count=u.shape[-1])


def ssd_scan(xs, dt, a, bm, cm):
    bsz, seq = xs.shape[:2]
    nc = seq // SSD_CHUNK
    xc = xs.reshape(bsz, nc, SSD_CHUNK, SSD_GROUPS, HEADS_PER_GROUP, SSD_HEAD_DIM)
    dtc = dt.reshape(bsz, nc, SSD_CHUNK, SSD_GROUPS, HEADS_PER_GROUP)
    bc = bm.reshape(bsz, nc, SSD_CHUNK, SSD_GROUPS, SSD_STATE)
    cc = cm.reshape(bsz, nc, SSD_CHUNK, SSD_GROUPS, SSD_STATE)
    a_cum = jnp.cumsum(dtc * a.reshape(SSD_GROUPS, HEADS_PER_GROUP), axis=2)
    x_dt = xc * dtc[..., None]
    seg = a_cum[:, :, :, None] - a_cum[:, :, None, :]
    causal_in_chunk = (jnp.arange(SSD_CHUNK)[:, None] >= jnp.arange(SSD_CHUNK)[None, :])
    decay = jnp.exp(jnp.where(causal_in_chunk[None, None, :, :, None, None], seg, -jnp.inf))
    cb = jnp.einsum("bclgn,bcsgn->bclsg", cc, bc)
    y_diag = jnp.einsum("bclsg,bclsgr,bcsgrp->bclgrp", cb, decay, x_dt)
    decay_to_end = jnp.exp(a_cum[:, :, -1:] - a_cum)
    chunk_states = jnp.einsum("bcsgn,bcsgr,bcsgrp->bcgrpn", bc, decay_to_end, x_dt)
    chunk_decay = jnp.exp(a_cum[:, :, -1])

    def step(state, inp):
        st_c, dec_c = inp
        return state * dec_c[..., None, None] + st_c, state

    init = jnp.zeros_like(chunk_states[:, 0])
    _, prev = lax.scan(step, init, (jnp.moveaxis(chunk_states, 1, 0), jnp.moveaxis(chunk_decay, 1, 0)))
    prev = jnp.moveaxis(prev, 0, 1)
    y_off = jnp.einsum("bclgn,bcgrpn,bclgr->bclgrp", cc, prev, jnp.exp(a_cum))
    return (y_diag + y_off).reshape(bsz, seq, SSD_GROUPS, HEADS_PER_GROUP, SSD_HEAD_DIM)


def hybrid_mixer(h, w_in, conv_a_w, ssd_conv_w, ssd_conv_b, dt_bias_fw, dt_bias_bw,
                 a_log_fw, a_log_bw, d_skip, ssd_norm_w, w_out):
    bsz, seq, _ = h.shape
    proj = jnp.einsum("bsd,de->bse", h, w_in)
    gate_b, gate_c, u, z, xbc, dt_raw = jnp.split(proj, COL_SPLITS, axis=-1)
    y_a = gate_b * depthwise_conv(gate_c * u, conv_a_w)
    xbc = jax.nn.silu(depthwise_conv(xbc, ssd_conv_w) + ssd_conv_b.astype(xbc.dtype))
    xs, bm, cm = jnp.split(xbc, (D_SSD, D_SSD + SSD_GROUPS * SSD_STATE), axis=-1)
    xs = xs.reshape(bsz, seq, SSD_GROUPS, HEADS_PER_GROUP, SSD_HEAD_DIM)
    bm = bm.reshape(bsz, seq, SSD_GROUPS, SSD_STATE)
    cm = cm.reshape(bsz, seq, SSD_GROUPS, SSD_STATE)
    dt_raw = dt_raw.astype(jnp.float32)
    dt_fw = jax.nn.softplus(dt_raw[..., :SSD_HEADS] + dt_bias_fw.astype(jnp.float32))
    dt_bw = jax.nn.softplus(dt_raw[..., SSD_HEADS:] + dt_bias_bw.astype(jnp.float32))
    a_fw = -jnp.exp(a_log_fw.astype(jnp.float32))
    a_bw = -jnp.exp(a_log_bw.astype(jnp.float32))
    y_fw = ssd_scan(xs, dt_fw, a_fw, bm, cm)
    y_bw = jnp.flip(ssd_scan(jnp.flip(xs, 1), jnp.flip(dt_bw, 1), a_bw,
                             jnp.flip(bm, 1), jnp.flip(cm, 1)), 1)
    y_b = y_fw + y_bw + xs * d_skip.reshape(SSD_GROUPS, HEADS_PER_GROUP)[..., None]
    g = (y_b.reshape(bsz, seq, D_SSD) * jax.nn.silu(z)).astype(jnp.float32)
    g = g.reshape(bsz, seq, SSD_GROUPS, D_SSD // SSD_GROUPS)
    g = g * lax.rsqrt(jnp.mean(g * g, axis=-1, keepdims=True) + EPS)
    y_b = (g.reshape(bsz, seq, D_SSD) * ssd_norm_w.astype(jnp.float32)).astype(h.dtype)
    y = jnp.concatenate([y_a.astype(h.dtype), y_b], axis=-1)
    return jnp.einsum("bse,ed->bsd", y, w_out).astype(h.dtype)


def moe_ffn(h, w_router, b_router, w_gate_up, b_gate_up, w_down, b_down):
    bsz, seq, d = h.shape
    ht = h.reshape(-1, d)
    n_tok = ht.shape[0]
    logits = (ht @ w_router + b_router).astype(jnp.float32)
    top_logits, top_idx = lax.top_k(logits, TOP_K)
    gates = jax.nn.softmax(top_logits, axis=-1)
    n_slots = n_tok * TOP_K
    e_flat = top_idx.reshape(-1)
    order = jnp.argsort(e_flat)
    e_sorted = e_flat[order]
    counts = jnp.bincount(e_flat, length=N_EXPERTS)
    starts = jnp.cumsum(counts) - counts
    padded = (counts + MOE_BLOCK - 1) // MOE_BLOCK * MOE_BLOCK
    pends = jnp.cumsum(padded)
    pstarts = pends - padded
    dest = pstarts[e_sorted] + jnp.arange(n_slots, dtype=jnp.int32) - starts[e_sorted]
    n_blocks = -(-n_slots // MOE_BLOCK) + N_EXPERTS
    n_rows = n_blocks * MOE_BLOCK
    row_tok = jnp.zeros((n_rows,), jnp.int32).at[dest].set((order // TOP_K).astype(jnp.int32))
    row_gate = jnp.zeros((n_rows,), jnp.float32).at[dest].set(gates.reshape(-1)[order])
    block_e = jnp.minimum(
        jnp.searchsorted(pends, jnp.arange(n_blocks) * MOE_BLOCK, side="right"), N_EXPERTS - 1)

    def expert_block(args):
        tok, gate, e = args
        xb = ht[tok]
        gu = xb @ w_gate_up[e] + b_gate_up[e]
        x_glu = jnp.minimum(gu[:, :D_FF], SWIGLU_LIMIT)
        x_lin = jnp.clip(gu[:, D_FF:], -SWIGLU_LIMIT, SWIGLU_LIMIT)
        act = x_glu * jax.nn.sigmoid(SWIGLU_ALPHA * x_glu) * (x_lin + 1.0)
        yb = act @ w_down[e] + b_down[e]
        return yb.astype(jnp.float32) * gate[:, None]

    ys = lax.map(expert_block, (row_tok.reshape(n_blocks, MOE_BLOCK),
                                row_gate.reshape(n_blocks, MOE_BLOCK), block_e))
    out = jax.ops.segment_sum(ys.reshape(n_rows, d), row_tok, num_segments=n_tok)
    return out.reshape(bsz, seq, d).astype(h.dtype)


def setup_inputs(seed: int = 0) -> dict:
    key = jax.random.key(seed)
    ks = jax.random.split(key, 24)
    f32 = jnp.float32
    nrm = lambda k, shape, scale: jax.random.normal(k, shape, f32) * scale

    def dt_bias(k):
        dt = jnp.exp(jax.random.uniform(k, (DEPTH, SSD_HEADS), f32)
                     * (math.log(0.1) - math.log(0.001)) + math.log(0.001))
        return dt + jnp.log(-jnp.expm1(-dt))

    def a_log(k):
        return jnp.log(jax.random.uniform(k, (DEPTH, SSD_HEADS), f32, 1.0, 16.0))

    return {
        "x": nrm(ks[0], (BATCH, SEQ, D_MODEL), 1.0),
        "norm_mix_w": 1.0 + nrm(ks[1], (DEPTH, D_MODEL), 0.02),
        "w_in": nrm(ks[2], (DEPTH, D_MODEL, IN_COLS), D_MODEL ** -0.5),
        "conv_a_w": nrm(ks[3], (DEPTH, CONV_A_WIDTH, D_CONV_MIX), CONV_A_WIDTH ** -0.5),
        "ssd_conv_w": nrm(ks[4], (DEPTH, SSD_CONV_WIDTH, D_XBC), SSD_CONV_WIDTH ** -0.5),
        "ssd_conv_b": nrm(ks[5], (DEPTH, D_XBC), 0.01),
        "dt_bias_fw": dt_bias(ks[6]),
        "dt_bias_bw": dt_bias(ks[7]),
        "a_log_fw": a_log(ks[8]),
        "a_log_bw": a_log(ks[9]),
        "d_skip": 1.0 + nrm(ks[10], (DEPTH, SSD_HEADS), 0.1),
        "ssd_norm_w": 1.0 + nrm(ks[11], (DEPTH, D_SSD), 0.02),
        "w_out": nrm(ks[12], (DEPTH, D_MIX, D_MODEL), D_MIX ** -0.5),
        "norm_ffn_w": 1.0 + nrm(ks[13], (DEPTH, D_MODEL), 0.02),
        "w_router": nrm(ks[14], (DEPTH, D_MODEL, N_EXPERTS), D_MODEL ** -0.5),
        "b_router": nrm(ks[15], (DEPTH, N_EXPERTS), 0.01),
        "w_gate_up": nrm(ks[16], (DEPTH, N_EXPERTS, D_MODEL, 2 * D_FF), D_MODEL ** -0.5),
        "b_gate_up": nrm(ks[17], (DEPTH, N_EXPERTS, 2 * D_FF), 0.01),
        "w_down": nrm(ks[18], (DEPTH, N_EXPERTS, D_FF, D_MODEL), D_FF ** -0.5),
        "b_down": nrm(ks[19], (DEPTH, N_EXPERTS, D_MODEL), 0.01),
        "norm_final_w": 1.0 + nrm(ks[20], (D_MODEL,), 0.02),
    }


def reference(x, norm_mix_w, w_in, conv_a_w, ssd_conv_w, ssd_conv_b, dt_bias_fw, dt_bias_bw,
              a_log_fw, a_log_bw, d_skip, ssd_norm_w, w_out, norm_ffn_w, w_router, b_router,
              w_gate_up, b_gate_up, w_down, b_down, norm_final_w):
    for layer in range(DEPTH):
        h = rms_norm(x, norm_mix_w[layer])
        x = x + hybrid_mixer(h, w_in[layer], conv_a_w[layer], ssd_conv_w[layer], ssd_conv_b[layer],
                             dt_bias_fw[layer], dt_bias_bw[layer], a_log_fw[layer], a_log_bw[layer],
                             d_skip[layer], ssd_norm_w[layer], w_out[layer])
        h = rms_norm(x, norm_ffn_w[layer])
        x = x + moe_ffn(h, w_router[layer], b_router[layer], w_gate_up[layer], b_gate_up[layer],
                        w_down[layer], b_down[layer])
    return rms_norm(x, norm_final_w)
```

```cpp
#include <hip/hip_runtime.h>
#include <cstdio>
#include <cstdint>

#ifndef MK_N_LAUNCHES
#define MK_N_LAUNCHES 0
#endif
#ifndef MK_LAST_PHASE
#define MK_LAST_PHASE 99
#endif

#define LAS __attribute__((address_space(3)))
typedef unsigned short bf16_t;
typedef short bf16x8 __attribute__((ext_vector_type(8)));
typedef short s16x4 __attribute__((ext_vector_type(4)));
typedef short v4i16_t __attribute__((ext_vector_type(4)));
typedef float f32x4 __attribute__((ext_vector_type(4)));
typedef unsigned u32x4 __attribute__((ext_vector_type(4)));
typedef unsigned u32x2 __attribute__((ext_vector_type(2)));

constexpr int T = 32768, D = 2048, SEQ = 2048, NBATCH = 16;
constexpr int NPROJ = 6176, NP = 6400;
constexpr int COL_GB = 0, COL_GC = 1024, COL_U = 2048, COL_Z = 3072, COL_XBC = 4096, COL_DT = 6144;
constexpr int NE = 32, TOPK = 4, DFF = 2048;
constexpr int NSLOT = T * TOPK;
constexpr int MAXTILES = NSLOT / 256 + NE;
constexpr int MAXROWS = MAXTILES * 256;
constexpr int NCHUNK = T / 128;
constexpr float EPS = 1e-5f;

constexpr size_t MiB = 1ull << 20;
constexpr size_t alup(size_t x) { return (x + MiB - 1) / MiB * MiB; }
constexpr size_t WS_CTL = 0, CTL_ZERO_BYTES = 1 * MiB;
constexpr size_t WS_WIN = 1 * MiB;
constexpr size_t WS_WOUT = WS_WIN + alup((size_t)NP * D * 2);
constexpr size_t WS_WR = WS_WOUT + alup((size_t)D * D * 2);
constexpr size_t WS_WGU = WS_WR + alup((size_t)256 * D * 2);
constexpr size_t WS_WDN = WS_WGU + alup((size_t)NE * 4096 * D * 2);
constexpr size_t WS_H = WS_WDN + alup((size_t)NE * D * DFF * 2);
constexpr size_t WS_PROJ = WS_H + alup((size_t)T * D * 2);
constexpr size_t WS_XBC = WS_PROJ + alup((size_t)T * NP * 2);
constexpr size_t WS_DT = WS_XBC + alup((size_t)T * 2048 * 2);
constexpr size_t WS_PREV = WS_DT + alup((size_t)4 * T * 16 * 4);
constexpr size_t WS_Y = WS_PREV + alup((size_t)NCHUNK * 2 * 16 * 64 * 128 * 2);
constexpr size_t WS_X1 = WS_Y + alup((size_t)T * 2048 * 2);
constexpr size_t WS_LOG = WS_X1 + alup((size_t)T * D * 4);
constexpr size_t WS_TOPI = WS_LOG + alup((size_t)T * 32 * 4);
constexpr size_t WS_TOPG = WS_TOPI + alup((size_t)T * 4 * 4);
constexpr size_t WS_TOPP = WS_TOPG + alup((size_t)T * 4 * 4);
constexpr size_t WS_INV = WS_TOPP + alup((size_t)T * 4 * 4);
constexpr size_t WS_ROWTOK = WS_INV + alup((size_t)T * 4 * 4);
constexpr size_t WS_ROWGATE = WS_ROWTOK + alup((size_t)MAXROWS * 4);
constexpr size_t WS_ACT = WS_ROWGATE + alup((size_t)MAXROWS * 4);
constexpr size_t WS_YSLOT = WS_ACT + alup((size_t)MAXROWS * DFF * 2);
constexpr size_t WS_END = WS_YSLOT + alup((size_t)MAXROWS * D * 2);
constexpr int CW_BAR = 4096;
constexpr int CW_GCOUNT = 8192;
constexpr int CW_NT = 8320;
constexpr int CW_TILEE = 8448;

constexpr int LDS_CTL_OFF = 152 * 1024;
constexpr int LDS_BYTES = LDS_CTL_OFF + 1024;

#define LDS_WAIT() asm volatile("s_waitcnt lgkmcnt(0)" ::: "memory")
#define VM_WAIT() asm volatile("s_waitcnt vmcnt(0)" ::: "memory")
__device__ __forceinline__ unsigned f2bf(float f) { unsigned u = __builtin_bit_cast(unsigned, f); return (u + 0x7fffu + ((u >> 16) & 1u)) >> 16; }
__device__ __forceinline__ unsigned pk2(float lo, float hi) { return f2bf(lo) | (f2bf(hi) << 16); }
__device__ __forceinline__ unsigned cvt_pk_bf16(float lo, float hi) { unsigned r; asm volatile("v_cvt_pk_bf16_f32 %0, %1, %2" : "=v"(r) : "v"(lo), "v"(hi)); return r; }
__device__ __forceinline__ float bf_lo(unsigned u) { return __builtin_bit_cast(float, u << 16); }
__device__ __forceinline__ float bf_hi(unsigned u) { return __builtin_bit_cast(float, u & 0xffff0000u); }
__device__ __forceinline__ float bf1(bf16_t b) { return __builtin_bit_cast(float, ((unsigned)b) << 16); }
__device__ __forceinline__ void unpack8(const u32x4 v, float (&f)[8]) {
    f[0] = bf_lo(v.x); f[1] = bf_hi(v.x); f[2] = bf_lo(v.y); f[3] = bf_hi(v.y); f[4] = bf_lo(v.z); f[5] = bf_hi(v.z); f[6] = bf_lo(v.w); f[7] = bf_hi(v.w);
}
__device__ __forceinline__ float wave_sum(float v) {
#pragma unroll
    for (int o = 1; o < 64; o <<= 1) v += __shfl_xor(v, o);
    return v;
}
__device__ __forceinline__ float fast_exp(float x) { return __builtin_amdgcn_exp2f(x * 1.44269504089f); }
__device__ __forceinline__ float sigmoidf(float x) { return __builtin_amdgcn_rcpf(1.0f + fast_exp(-x)); }
__device__ __forceinline__ float siluf(float x) { return x * sigmoidf(x); }
__device__ __forceinline__ unsigned ld_agent(const unsigned* p) { return __hip_atomic_load(p, __ATOMIC_RELAXED, __HIP_MEMORY_SCOPE_AGENT); }

#define XB_TMO      128
#define XB_XCNT(j)  (256  + 64 * (j))
#define XB_XSUB(j)  (1280 + 64 * (j))
#define XB_XGEN(j)  (2304 + 64 * (j))
#define XB_TOP      3328
#define XB_TOPGEN   3392
#define XCD_BAR_WORDS 3456
#define XB_SPIN_CAP (1u << 20)

__device__ __forceinline__ unsigned xb_ld(unsigned* p)              { return __hip_atomic_load(p, __ATOMIC_RELAXED, __HIP_MEMORY_SCOPE_AGENT); }
__device__ __forceinline__ unsigned xb_add(unsigned* p, unsigned v) { return __hip_atomic_fetch_add(p, v, __ATOMIC_RELAXED, __HIP_MEMORY_SCOPE_AGENT); }
__device__ __forceinline__ unsigned xb_xcc_id() { return (unsigned)__builtin_amdgcn_s_getreg((3 << 11) | 20) & 0xFu; }
#define XB_SPIN(cond, bar) do { unsigned _sp = 0; while (cond) { __builtin_amdgcn_s_sleep(1); \
    if ((++_sp & 255u) == 0u) { if (xb_ld(&(bar)[XB_TMO])) break; if (_sp > XB_SPIN_CAP) { atomicAdd(&(bar)[XB_TMO], 1u); break; } } } } while (0)

struct XcdBarrier { unsigned* bar; unsigned x; volatile LAS unsigned* st; };

__device__ __forceinline__ XcdBarrier xcd_barrier_post(unsigned* bar, volatile LAS unsigned* st) {
    XcdBarrier b; b.bar = bar; b.x = xb_xcc_id(); b.st = st;
    if (threadIdx.x == 0) (void)xb_add(&bar[XB_XCNT(b.x)], 1u);
    return b;
}
__device__ __forceinline__ void xcd_barrier_complete(unsigned* bar, unsigned x, unsigned& nloc, unsigned& nx) {
    const unsigned G = gridDim.x * gridDim.y * gridDim.z;
    unsigned sum, cnt, mine, sp = 0u;
    for (;;) {
        sum = 0u; cnt = 0u; mine = 0u;
#pragma unroll
        for (unsigned j = 0; j < 16; ++j) { const unsigned c = xb_ld(&bar[XB_XCNT(j)]); sum += c; cnt += (c > 0u) ? 1u : 0u; mine = (j == x) ? c : mine; }
        if (sum == G) break;
        __builtin_amdgcn_s_sleep(1);
        if ((++sp & 255u) == 0u) { if (xb_ld(&bar[XB_TMO])) break; if (sp > XB_SPIN_CAP) { atomicAdd(&bar[XB_TMO], 1u); break; } }
    }
    nloc = mine > 0u ? mine : 1u; nx = cnt > 0u ? cnt : 1u;
}
__device__ __forceinline__ void xcd_barrier(const XcdBarrier& b) {
    asm volatile("s_waitcnt vmcnt(0)" ::: "memory");
    __syncthreads();
    if (threadIdx.x == 0) {
        unsigned* bar = b.bar;
        __builtin_amdgcn_s_waitcnt(0);
        unsigned nloc = b.st[0], nx = b.st[1];
        if (nloc == 0u) { xcd_barrier_complete(bar, b.x, nloc, nx); b.st[0] = nloc; b.st[1] = nx; }
        const unsigned old = xb_add(&bar[XB_XSUB(b.x)], 1u);
        const unsigned gen = old / nloc;
        if (old + 1u == (gen + 1u) * nloc) {
            __builtin_amdgcn_fence(__ATOMIC_RELEASE, "agent");
            asm volatile("s_waitcnt vmcnt(0)" ::: "memory");
            const unsigned og = xb_add(&bar[XB_TOP], 1u);
            const unsigned tg = og / nx;
            if (og + 1u == (tg + 1u) * nx) xb_add(&bar[XB_TOPGEN], 1u);
            else XB_SPIN(xb_ld(&bar[XB_TOPGEN]) == tg, bar);
            __builtin_amdgcn_fence(__ATOMIC_ACQUIRE, "agent");
            xb_add(&bar[XB_XGEN(b.x)], 1u);
            asm volatile("s_waitcnt vmcnt(0)" ::: "memory");
        } else {
            XB_SPIN(xb_ld(&bar[XB_XGEN(b.x)]) == gen, bar);
            __builtin_amdgcn_fence(__ATOMIC_ACQUIRE, "agent");
            asm volatile("s_waitcnt vmcnt(0)" ::: "memory");
        }
    }
    __syncthreads();
}

namespace pg8 {
constexpr int BM = 256, BK = 64, HALF = 128, HTB = HALF * BK * 2, STAGE_BYTES = 8 * HTB, NXCD = 8, WGM = 8;
__device__ __forceinline__ int lds_byte(int r, int c) { const int st = (r >> 4) * 2 + (c >> 5), rr = r & 15, cc = c & 31, ob = rr * 64 + cc * 2; return st * 1024 + (ob ^ (((ob >> 9) & 1) << 5)); }
__device__ __forceinline__ void stage_rc(int b, int& R, int& C) { const int st = b / 1024, sb = b % 1024, swz = sb ^ (((sb >> 9) & 1) << 5); R = (st >> 1) * 16 + swz / 64; C = (st & 1) * 32 + (swz % 64) / 2; }
__device__ __forceinline__ int perm32(int rho) { const int n = rho >> 4, i = rho & 15; return 8 * (i >> 2) + 4 * n + (i & 3); }

struct Unit { int pm, pn; };
struct OrderBase {
    int nM, nN, nwg, G, c;
    __device__ __forceinline__ void init(int nM_, int nN_, int G_, int c_) { nM = nM_; nN = nN_; nwg = nM * nN; G = G_; c = c_; }
    __device__ __forceinline__ bool next(int i, Unit& u) const {
        const long L = (long)i * G + c; if (L >= nwg) return false;
        int wgid = (int)L; { const int q = nwg / NXCD, r = nwg % NXCD, xcd = wgid % NXCD, off = wgid / NXCD; wgid = (xcd < r ? xcd * (q + 1) : r * (q + 1) + (xcd - r) * q) + off; }
        const int nig = WGM * nN, gid = wgid / nig, fm = gid * WGM, gsz = (nM - fm) < WGM ? (nM - fm) : WGM;
        u.pm = fm + ((wgid % nig) % gsz); u.pn = (wgid % nig) / gsz; return true;
    }
};
struct SchedPlain : OrderBase {
    static constexpr bool GATHER = false;
    __device__ __forceinline__ size_t a_off(const Unit& u, int K) const { return (size_t)u.pm * 256 * K * 2; }
    __device__ __forceinline__ size_t b_off(const Unit& u, int K) const { return (size_t)u.pn * 256 * K * 2; }
    __device__ __forceinline__ unsigned rowidx(const Unit&, int) const { return 0u; }
};
struct SchedUp : OrderBase {
    static constexpr bool GATHER = true;
    const int* row_tok; const unsigned* tile_e;
    __device__ __forceinline__ size_t a_off(const Unit&, int) const { return 0; }
    __device__ __forceinline__ size_t b_off(const Unit& u, int K) const { return ((size_t)ld_agent(tile_e + u.pm) * 4096 + (size_t)u.pn * 256) * K * 2; }
    __device__ __forceinline__ unsigned rowidx(const Unit& u, int r) const { return (unsigned)row_tok[u.pm * 256 + r]; }
};
struct SchedDown : OrderBase {
    static constexpr bool GATHER = false;
    const unsigned* tile_e;
    __device__ __forceinline__ size_t a_off(const Unit& u, int K) const { return (size_t)u.pm * 256 * K * 2; }
    __device__ __forceinline__ size_t b_off(const Unit& u, int K) const { return ((size_t)ld_agent(tile_e + u.pm) * 2048 + (size_t)u.pn * 256) * K * 2; }
    __device__ __forceinline__ unsigned rowidx(const Unit&, int) const { return 0u; }
};

template <class Epi, class Sched>
__device__ __forceinline__ void gemm_phase(LAS unsigned char* lds, const char* Abase, const char* Bbase, const int K, const Sched& S, const Epi& E) {
    constexpr bool GATHER = Sched::GATHER;
    const int tid = threadIdx.x, wid = __builtin_amdgcn_readfirstlane(tid >> 6), lane = tid & 63, wr = wid >> 2, wc = wid & 3, fr = lane & 15, fq = lane >> 4;
    const int nt = K / BK;
    unsigned voffA[2], voffB[2]; int RA[2], CA[2];
#pragma unroll
    for (int i = 0; i < 2; ++i) { int R, C; stage_rc(tid * 16 + i * 8192, R, C); const int Rb = Epi::PERM ? ((R & ~31) + perm32(R & 31)) : R;
        RA[i] = R; CA[i] = C; voffA[i] = (unsigned)(R * K + C) * 2u; voffB[i] = (unsigned)(Rb * K + C) * 2u; }
    const size_t kstep = (size_t)(BK * 2);
    const size_t hstep = (size_t)HALF * K * 2;
    const unsigned ldsw = (unsigned)wid * 1024u;
    const int aoff = lds_byte(wr * 64 + fr, fq * 8), boff = lds_byte(wc * 32 + fr, fq * 8);
#define PG8_SA(b, h) (((b) * 2 + (h)) * HTB)
#define PG8_SB(b, h) ((4 + (b) * 2 + (h)) * HTB)
#define PG8_GLDS(bufoff, gbase, v0, v1) do { \
        __builtin_amdgcn_global_load_lds((const unsigned*)((const char*)(gbase) + (v0)), (LAS unsigned*)(lds + (bufoff) + ldsw), 16, 0, 0); \
        __builtin_amdgcn_global_load_lds((const unsigned*)((const char*)(gbase) + (v1)), (LAS unsigned*)(lds + (bufoff) + ldsw + 8192), 16, 0, 0); } while (0)
#define PG8_STAGE_B(bufoff, gbase) PG8_GLDS(bufoff, gbase, voffB[0], voffB[1])
#define PG8_STAGE_A(bufoff, gbase, hh, o) do { if constexpr (GATHER) PG8_GLDS(bufoff, gbase, (o)[hh][0], (o)[hh][1]); else PG8_GLDS(bufoff, (gbase) + (hh) * hstep, voffA[0], voffA[1]); } while (0)
#define PG8_LDA(dst, b, h) do { _Pragma("unroll") for (int m = 0; m < 4; ++m) _Pragma("unroll") for (int k = 0; k < 2; ++k) dst[m][k] = *(const LAS bf16x8*)(lds + PG8_SA(b, h) + aoff + m * 2048 + k * 1024); } while (0)
#define PG8_LDB(dst, b, h) do { _Pragma("unroll") for (int n = 0; n < 2; ++n) _Pragma("unroll") for (int k = 0; k < 2; ++k) dst[n][k] = *(const LAS bf16x8*)(lds + PG8_SB(b, h) + boff + n * 2048 + k * 1024); } while (0)
#define PG8_MMA(ai, bj, At, Bt) do { __builtin_amdgcn_s_setprio(1); _Pragma("unroll") for (int m = 0; m < 4; ++m) _Pragma("unroll") for (int n = 0; n < 2; ++n) _Pragma("unroll") for (int k = 0; k < 2; ++k) \
        acc[ai][bj][m][n] = __builtin_amdgcn_mfma_f32_16x16x32_bf16(Bt[n][k], At[m][k], acc[ai][bj][m][n], 0, 0, 0); __builtin_amdgcn_s_setprio(0); } while (0)
#define PG8_WAIT_V(n) asm volatile("s_waitcnt vmcnt(" #n ")" ::: "memory")
#define PG8_WAIT_L(n) asm volatile("s_waitcnt lgkmcnt(" #n ")" ::: "memory")
#define PG8_BAR __builtin_amdgcn_s_barrier()
#define PG8_SCHED __builtin_amdgcn_sched_barrier(0)
    Unit cur, nxt; int ui = 0;
    if (!S.next(0, cur)) return;
    f32x4 acc[2][2][4][2];
#pragma unroll
    for (int a = 0; a < 2; ++a)
#pragma unroll
        for (int b = 0; b < 2; ++b)
#pragma unroll
            for (int m = 0; m < 4; ++m)
#pragma unroll
                for (int n = 0; n < 2; ++n) acc[a][b][m][n] = (f32x4){0.f, 0.f, 0.f, 0.f};
    bf16x8 At[4][2], B0[2][2], B1[2][2];
    unsigned vo[2][2], vo2[2][2];
#pragma unroll
    for (int hh = 0; hh < 2; ++hh)
#pragma unroll
        for (int i = 0; i < 2; ++i) { vo[hh][i] = GATHER ? (S.rowidx(cur, hh * 128 + RA[i]) * (unsigned)(K * 2) + (unsigned)CA[i] * 2u) : 0u; vo2[hh][i] = vo[hh][i]; }
    const char* cA = Abase + S.a_off(cur, K); const char* cB = Bbase + S.b_off(cur, K);
    PG8_STAGE_B(PG8_SB(0, 0), cB); PG8_STAGE_B(PG8_SB(0, 1), cB + hstep); PG8_STAGE_A(PG8_SA(0, 0), cA, 0, vo); PG8_STAGE_A(PG8_SA(0, 1), cA, 1, vo);
    if (wr == 1) PG8_BAR;
    PG8_WAIT_V(2); PG8_BAR;
    PG8_STAGE_B(PG8_SB(1, 0), cB + kstep); PG8_STAGE_A(PG8_SA(1, 0), cA + kstep, 0, vo); PG8_STAGE_B(PG8_SB(1, 1), cB + hstep + kstep);
    PG8_WAIT_V(6); PG8_BAR;
    for (;;) {
        const bool has_next = S.next(ui + 1, nxt);
        const char* nA = has_next ? Abase + S.a_off(nxt, K) : cA; const char* nB = has_next ? Bbase + S.b_off(nxt, K) : cB;
        for (int t = 0; t < nt; t += 2) {
            const bool last = (t == nt - 2);
            const char* a1 = cA + (size_t)(t + 1) * kstep;
            const char* a2 = last ? nA : cA + (size_t)(t + 2) * kstep; const char* b2 = last ? nB : cB + (size_t)(t + 2) * kstep;
            const char* a3 = a2 + kstep; const char* b3 = b2 + kstep;
            if constexpr (GATHER) { if (last && has_next) {
#pragma unroll
                for (int hh = 0; hh < 2; ++hh)
#pragma unroll
                    for (int i = 0; i < 2; ++i) vo2[hh][i] = S.rowidx(nxt, hh * 128 + RA[i]) * (unsigned)(K * 2) + (unsigned)CA[i] * 2u; } }
            PG8_LDB(B0, 0, 0); PG8_LDB(B1, 0, 1); PG8_SCHED; PG8_LDA(At, 0, 0); PG8_STAGE_A(PG8_SA(1, 1), a1, 1, vo);
            PG8_WAIT_V(8); PG8_WAIT_L(0); PG8_BAR; PG8_MMA(0, 0, At, B0); PG8_MMA(0, 1, At, B1); PG8_BAR; PG8_SCHED;
            PG8_LDA(At, 0, 1); PG8_STAGE_B(PG8_SB(0, 0), b2); PG8_STAGE_B(PG8_SB(0, 1), b2 + hstep); PG8_STAGE_A(PG8_SA(0, 0), a2, 0, vo2);
            PG8_WAIT_V(8); PG8_WAIT_L(0); PG8_BAR; PG8_MMA(1, 0, At, B0); PG8_MMA(1, 1, At, B1); PG8_BAR; PG8_SCHED;
            PG8_LDB(B0, 1, 0); PG8_LDB(B1, 1, 1); PG8_SCHED; PG8_LDA(At, 1, 0); PG8_STAGE_A(PG8_SA(0, 1), a2, 1, vo2);
            PG8_WAIT_V(8); PG8_WAIT_L(0); PG8_BAR; PG8_MMA(0, 0, At, B0); PG8_MMA(0, 1, At, B1); PG8_BAR; PG8_SCHED;
            PG8_LDA(At, 1, 1); PG8_STAGE_B(PG8_SB(1, 0), b3); PG8_STAGE_B(PG8_SB(1, 1), b3 + hstep); PG8_STAGE_A(PG8_SA(1, 0), a3, 0, vo2);
            PG8_WAIT_V(8); PG8_WAIT_L(0); PG8_BAR; PG8_MMA(1, 0, At, B0); PG8_MMA(1, 1, At, B1); PG8_BAR; PG8_SCHED;
        }
        if (wr == 0) PG8_BAR;
        E(acc, cur, wr, wc, fr, fq);
        if (!has_next) break;
#pragma unroll
        for (int a = 0; a < 2; ++a)
#pragma unroll
            for (int b = 0; b < 2; ++b)
#pragma unroll
                for (int m = 0; m < 4; ++m)
#pragma unroll
                    for (int n = 0; n < 2; ++n) acc[a][b][m][n] = (f32x4){0.f, 0.f, 0.f, 0.f};
        cur = nxt; cA = nA; cB = nB; ++ui;
#pragma unroll
        for (int hh = 0; hh < 2; ++hh)
#pragma unroll
            for (int i = 0; i < 2; ++i) vo[hh][i] = vo2[hh][i];
        if (wr == 1) PG8_BAR;
    }
    PG8_WAIT_V(0);
    PG8_BAR;
#undef PG8_SA
#undef PG8_SB
#undef PG8_GLDS
#undef PG8_STAGE_A
#undef PG8_STAGE_B
#undef PG8_LDA
#undef PG8_LDB
#undef PG8_MMA
#undef PG8_WAIT_V
#undef PG8_WAIT_L
#undef PG8_BAR
#undef PG8_SCHED
}

struct EpiProj {
    static constexpr bool PERM = true;
    bf16_t* O; int ldc;
    __device__ __forceinline__ void operator()(const f32x4 (&acc)[2][2][4][2], const Unit& u, int wr, int wc, int fr, int fq) const {
        const int row0 = u.pm * BM + wr * 64 + fr, col0 = u.pn * BM + wc * 32 + 8 * fq;
#pragma unroll
        for (int ai = 0; ai < 2; ++ai)
#pragma unroll
            for (int m = 0; m < 4; ++m) { bf16_t* rowp = O + (size_t)(row0 + ai * HALF + m * 16) * ldc + col0;
#pragma unroll
                for (int bj = 0; bj < 2; ++bj) { const f32x4 v0 = acc[ai][bj][m][0], v1 = acc[ai][bj][m][1];
                    u32x4 w; w.x = cvt_pk_bf16(v0[0], v0[1]); w.y = cvt_pk_bf16(v0[2], v0[3]); w.z = cvt_pk_bf16(v1[0], v1[1]); w.w = cvt_pk_bf16(v1[2], v1[3]);
                    *(u32x4*)(rowp + bj * HALF) = w; } }
    }
};
struct EpiRes {
    static constexpr bool PERM = false;
    const float* R; float* C;
    __device__ __forceinline__ void operator()(const f32x4 (&acc)[2][2][4][2], const Unit& u, int wr, int wc, int fr, int fq) const {
        const int row0 = u.pm * BM + wr * 64 + fr, col0 = u.pn * BM + wc * 32 + 4 * fq;
#pragma unroll
        for (int ai = 0; ai < 2; ++ai)
#pragma unroll
            for (int m = 0; m < 4; ++m) { const size_t ro = (size_t)(row0 + ai * HALF + m * 16) * D + col0;
#pragma unroll
                for (int bj = 0; bj < 2; ++bj)
#pragma unroll
                    for (int n = 0; n < 2; ++n) { const f32x4 r = *(const f32x4*)(R + ro + bj * HALF + n * 16); *(f32x4*)(C + ro + bj * HALF + n * 16) = r + acc[ai][bj][m][n]; } }
    }
};
struct EpiLogits {
    static constexpr bool PERM = false;
    float* L;
    __device__ __forceinline__ void operator()(const f32x4 (&acc)[2][2][4][2], const Unit& u, int wr, int wc, int fr, int fq) const {
        if (wc != 0 || u.pn != 0) return;
        const int row0 = u.pm * BM + wr * 64 + fr;
#pragma unroll
        for (int ai = 0; ai < 2; ++ai)
#pragma unroll
            for (int m = 0; m < 4; ++m) { float* rowp = L + (size_t)(row0 + ai * HALF + m * 16) * 32 + 4 * fq;
#pragma unroll
                for (int n = 0; n < 2; ++n) *(f32x4*)(rowp + n * 16) = acc[ai][0][m][n]; }
    }
};
struct EpiSwiglu {
    static constexpr bool PERM = true;
    bf16_t* O; const float* bgu; const unsigned* tile_e;
    __device__ __forceinline__ void operator()(const f32x4 (&acc)[2][2][4][2], const Unit& u, int wr, int wc, int fr, int fq) const {
        const unsigned e = ld_agent(tile_e + u.pm);
        const int row0 = u.pm * BM + wr * 64 + fr, cc0 = wc * 32 + 8 * fq;
        const float* bg = bgu + (size_t)e * 4096 + u.pn * 128 + cc0; const float* bl = bg + 2048;
        const f32x4 bg0 = *(const f32x4*)bg, bg1 = *(const f32x4*)(bg + 4), bl0 = *(const f32x4*)bl, bl1 = *(const f32x4*)(bl + 4);
#pragma unroll
        for (int ai = 0; ai < 2; ++ai)
#pragma unroll
            for (int m = 0; m < 4; ++m) {
                float o[8];
#pragma unroll
                for (int n = 0; n < 2; ++n) { const f32x4 g = acc[ai][0][m][n] + (n ? bg1 : bg0), l = acc[ai][1][m][n] + (n ? bl1 : bl0);
#pragma unroll
                    for (int j = 0; j < 4; ++j) { const float xg = fminf(g[j], 7.0f), xl = fminf(fmaxf(l[j], -7.0f), 7.0f); o[n * 4 + j] = xg * sigmoidf(1.702f * xg) * (xl + 1.0f); } }
                u32x4 w; w.x = cvt_pk_bf16(o[0], o[1]); w.y = cvt_pk_bf16(o[2], o[3]); w.z = cvt_pk_bf16(o[4], o[5]); w.w = cvt_pk_bf16(o[6], o[7]);
                *(u32x4*)(O + (size_t)(row0 + ai * HALF + m * 16) * DFF + u.pn * 128 + cc0) = w; }
    }
};
struct EpiDown {
    static constexpr bool PERM = true;
    bf16_t* O; const float* bdn; const float* row_gate; const unsigned* tile_e;
    __device__ __forceinline__ void operator()(const f32x4 (&acc)[2][2][4][2], const Unit& u, int wr, int wc, int fr, int fq) const {
        const unsigned e = ld_agent(tile_e + u.pm);
        const int row0 = u.pm * BM + wr * 64 + fr, col0 = u.pn * BM + wc * 32 + 8 * fq;
        const float* bp = bdn + (size_t)e * D + col0;
        f32x4 bv[2][2];
#pragma unroll
        for (int bj = 0; bj < 2; ++bj)
#pragma unroll
            for (int n = 0; n < 2; ++n) bv[bj][n] = *(const f32x4*)(bp + bj * HALF + 4 * n);
#pragma unroll
        for (int ai = 0; ai < 2; ++ai)
#pragma unroll
            for (int m = 0; m < 4; ++m) { const int row = row0 + ai * HALF + m * 16; const float gt = row_gate[row]; bf16_t* rowp = O + (size_t)row * D + col0;
#pragma unroll
                for (int bj = 0; bj < 2; ++bj) { const f32x4 v0 = (acc[ai][bj][m][0] + bv[bj][0]) * gt, v1 = (acc[ai][bj][m][1] + bv[bj][1]) * gt;
                    u32x4 w; w.x = cvt_pk_bf16(v0[0], v0[1]); w.y = cvt_pk_bf16(v0[2], v0[3]); w.z = cvt_pk_bf16(v1[0], v1[1]); w.w = cvt_pk_bf16(v1[2], v1[3]);
                    *(u32x4*)(rowp + bj * HALF) = w; } }
    }
};
}

__device__ __forceinline__ s16x4 ldtr(const LAS bf16_t* p) { return __builtin_bit_cast(s16x4, __builtin_amdgcn_ds_read_tr16_b64_v4i16((LAS v4i16_t*)p)); }
__device__ __forceinline__ bf16x8 frag_rowk(const LAS bf16_t* base, int ld, int row0, int k0, int lane) {
    return *(const LAS bf16x8*)(base + (row0 + (lane & 15)) * ld + k0 + 8 * (lane >> 4));
}
__device__ __forceinline__ bf16x8 frag_kcol(const LAS bf16_t* base, int ld, int k0, int col0, int lane) {
    const int g = lane >> 4, q = (lane >> 2) & 3, p = lane & 3;
    const LAS bf16_t* a = base + (k0 + 8 * g + q) * ld + col0 + 4 * p;
    const s16x4 lo = ldtr(a), hi = ldtr(a + 4 * ld);
    bf16x8 r; r[0] = lo[0]; r[1] = lo[1]; r[2] = lo[2]; r[3] = lo[3]; r[4] = hi[0]; r[5] = hi[1]; r[6] = hi[2]; r[7] = hi[3]; return r;
}
#define MFMA16(a, b, c) __builtin_amdgcn_mfma_f32_16x16x32_bf16((a), (b), (c), 0, 0, 0)

struct Args { const float* in[21]; float* out; unsigned char* ws; int ph_lo, ph_hi; };

__device__ __forceinline__ void transpose_item(const float* W, int N, int k0, int n0, bf16_t* dst, int K, LAS float* scr, int lane) {
    const bool ok = (n0 + lane) < N;
    const float* src = W + (size_t)k0 * N + n0 + lane;
#pragma unroll 16
    for (int i = 0; i < 64; ++i) scr[i * 65 + lane] = ok ? src[(size_t)i * N] : 0.f;
    LDS_WAIT(); asm volatile("" ::: "memory");
    const int c = lane & 7;
#pragma unroll
    for (int j = 0; j < 8; ++j) { const int n = (lane >> 3) + 8 * j; const LAS float* s = scr + (8 * c) * 65 + n;
        u32x4 o; o.x = pk2(s[0 * 65], s[1 * 65]); o.y = pk2(s[2 * 65], s[3 * 65]); o.z = pk2(s[4 * 65], s[5 * 65]); o.w = pk2(s[6 * 65], s[7 * 65]);
        *(u32x4*)(dst + (size_t)n * K + k0 + 8 * c) = o; }
    LDS_WAIT(); asm volatile("" ::: "memory");
}
__device__ __forceinline__ void rmsnorm_row_bf16(const float* xrow, const float* w, bf16_t* orow, int lane) {
    const f32x4* xr = (const f32x4*)xrow + lane;
    f32x4 v[8]; float s = 0.f;
#pragma unroll
    for (int j = 0; j < 8; ++j) { v[j] = xr[64 * j]; s += (v[j].x * v[j].x + v[j].y * v[j].y) + (v[j].z * v[j].z + v[j].w * v[j].w); }
    const float rstd = __builtin_amdgcn_rsqf(wave_sum(s) * (1.f / D) + EPS);
    const f32x4* wr_ = (const f32x4*)w + lane;
    u32x2* o8 = (u32x2*)orow + lane;
#pragma unroll
    for (int j = 0; j < 8; ++j) { const f32x4 wv = wr_[64 * j]; u32x2 o; o.x = pk2(v[j].x * rstd * wv.x, v[j].y * rstd * wv.y); o.y = pk2(v[j].z * rstd * wv.z, v[j].w * rstd * wv.w); o8[64 * j] = o; }
}

__device__ __forceinline__ void p0_prologue(const Args& a, LAS unsigned char* lds, int gw, int NGW, int wave, int lane) {
    unsigned char* ws = a.ws;
    LAS float* scr = (LAS float*)(lds + wave * 16640);
    bf16_t* WIN = (bf16_t*)(ws + WS_WIN); bf16_t* WOUT = (bf16_t*)(ws + WS_WOUT); bf16_t* WR = (bf16_t*)(ws + WS_WR); bf16_t* WGU = (bf16_t*)(ws + WS_WGU); bf16_t* WDN = (bf16_t*)(ws + WS_WDN);
    constexpr int I_IN = 32 * 97, I_OUT = 32 * 32, I_R = 32, I_GU = NE * 32 * 64, I_DN = NE * 32 * 32;
    constexpr int NITEMS = I_IN + I_OUT + I_R + I_GU + I_DN;
    for (int it = gw; it < NITEMS; it += NGW) {
        int r = it;
        if (r < I_IN) { const int kb = r / 97, nb = r % 97; transpose_item(a.in[2], NPROJ, kb * 64, nb * 64, WIN + (size_t)(nb * 64) * D, D, scr, lane); continue; } r -= I_IN;
        if (r < I_OUT) { const int kb = r / 32, nb = r % 32; transpose_item(a.in[12], D, kb * 64, nb * 64, WOUT + (size_t)(nb * 64) * D, D, scr, lane); continue; } r -= I_OUT;
        if (r < I_R) { transpose_item(a.in[14], NE, r * 64, 0, WR, D, scr, lane); continue; } r -= I_R;
        if (r < I_GU) { const int e = r / 2048, q = r % 2048, kb = q / 64, nb = q % 64; const int n0 = nb * 64;
            const int j0 = n0 & 2047, drow = (j0 >> 7) * 256 + (n0 >= 2048 ? 128 : 0) + (j0 & 127);
            transpose_item(a.in[16] + (size_t)e * D * 4096, 4096, kb * 64, n0, WGU + ((size_t)e * 4096 + drow) * D, D, scr, lane); continue; } r -= I_GU;
        { const int e = r / 1024, q = r % 1024, kb = q / 32, nb = q % 32;
            transpose_item(a.in[18] + (size_t)e * DFF * D, D, kb * 64, nb * 64, WDN + ((size_t)e * D + nb * 64) * DFF, DFF, scr, lane); }
    }
    { const int gt = gw * 64 + lane, ngt = NGW * 64; const u32x4 z = {0u, 0u, 0u, 0u};
      u32x4* p1 = (u32x4*)(WIN + (size_t)6208 * D); for (int i = gt; i < (6400 - 6208) * D / 8; i += ngt) p1[i] = z;
      u32x4* p2 = (u32x4*)(WR + (size_t)64 * D); for (int i = gt; i < (256 - 64) * D / 8; i += ngt) p2[i] = z; }
    bf16_t* H = (bf16_t*)(ws + WS_H);
    for (int m = gw; m < T; m += NGW) rmsnorm_row_bf16(a.in[0] + (size_t)m * D, a.in[1], H + (size_t)m * D, lane);
}

__device__ __forceinline__ void p2_conv(const Args& a, int gw, int NGW, int lane) {
    unsigned char* ws = a.ws;
    const bf16_t* PROJ = (const bf16_t*)(ws + WS_PROJ); bf16_t* Y = (bf16_t*)(ws + WS_Y); bf16_t* XBC = (bf16_t*)(ws + WS_XBC);
    float* DTF = (float*)(ws + WS_DT); float* DTB = DTF + (size_t)T * 16; float* ACF = DTB + (size_t)T * 16; float* ACB = ACF + (size_t)T * 16;
    constexpr int NCONV = (T / 16) * 6, NITEMS = NCONV + NCHUNK;
    for (int it = gw; it < NITEMS; it += NGW) {
        if (it < NCONV) {
            const int tb = it / 6, seg = it % 6, t0 = tb * 16, ts0 = t0 & (SEQ - 1);
            if (seg < 2) {
                const int c0 = (seg * 64 + lane) * 8;
                float w0[8], w1[8], w2[8];
                { const f32x4* p = (const f32x4*)(a.in[3] + c0); const f32x4 x0 = p[0], x1 = p[1], y0 = p[256], y1 = p[257], z0 = p[512], z1 = p[513];
#pragma unroll
                  for (int j = 0; j < 4; ++j) { w0[j] = x0[j]; w0[4 + j] = x1[j]; w1[j] = y0[j]; w1[4 + j] = y1[j]; w2[j] = z0[j]; w2[4 + j] = z1[j]; } }
                float vp[8], vc[8], vn[8];
#pragma unroll
                for (int j = 0; j < 8; ++j) { vp[j] = 0.f; vc[j] = 0.f; vn[j] = 0.f; }
#pragma unroll
                for (int i = -1; i <= 16; ++i) {
                    float v[8];
                    const int ts = ts0 + i;
                    if (ts >= 0 && ts < SEQ) { const bf16_t* rp = PROJ + (size_t)(t0 + i) * NP + c0; float g[8], u[8]; unpack8(*(const u32x4*)(rp + COL_GC), g); unpack8(*(const u32x4*)(rp + COL_U), u);
#pragma unroll
                        for (int j = 0; j < 8; ++j) v[j] = g[j] * u[j]; }
                    else {
#pragma unroll
                        for (int j = 0; j < 8; ++j) v[j] = 0.f; }
#pragma unroll
                    for (int j = 0; j < 8; ++j) { vp[j] = vc[j]; vc[j] = vn[j]; vn[j] = v[j]; }
                    if (i >= 1) { const int t = t0 + i - 1; float gb[8]; unpack8(*(const u32x4*)(PROJ + (size_t)t * NP + COL_GB + c0), gb); float o[8];
#pragma unroll
                        for (int j = 0; j < 8; ++j) o[j] = gb[j] * (w0[j] * vp[j] + w1[j] * vc[j] + w2[j] * vn[j]);
                        u32x4 w; w.x = pk2(o[0], o[1]); w.y = pk2(o[2], o[3]); w.z = pk2(o[4], o[5]); w.w = pk2(o[6], o[7]);
                        *(u32x4*)(Y + (size_t)t * 2048 + c0) = w; }
                }
            } else {
                const int c0 = ((seg - 2) * 64 + lane) * 8;
                float wk[5][8], bs[8];
#pragma unroll
                for (int k = 0; k < 5; ++k) { const f32x4* p = (const f32x4*)(a.in[4] + k * 2048 + c0); const f32x4 x0 = p[0], x1 = p[1];
#pragma unroll
                    for (int j = 0; j < 4; ++j) { wk[k][j] = x0[j]; wk[k][4 + j] = x1[j]; } }
                { const f32x4* p = (const f32x4*)(a.in[5] + c0); const f32x4 x0 = p[0], x1 = p[1];
#pragma unroll
                  for (int j = 0; j < 4; ++j) { bs[j] = x0[j]; bs[4 + j] = x1[j]; } }
                float x0[8], x1[8], x2[8], x3[8], x4[8];
#pragma unroll
                for (int j = 0; j < 8; ++j) { x0[j] = 0.f; x1[j] = 0.f; x2[j] = 0.f; x3[j] = 0.f; x4[j] = 0.f; }
#pragma unroll
                for (int i = -2; i <= 17; ++i) {
                    float v[8];
                    const int ts = ts0 + i;
                    if (ts >= 0 && ts < SEQ) unpack8(*(const u32x4*)(PROJ + (size_t)(t0 + i) * NP + COL_XBC + c0), v);
                    else {
#pragma unroll
                        for (int j = 0; j < 8; ++j) v[j] = 0.f; }
#pragma unroll
                    for (int j = 0; j < 8; ++j) { x0[j] = x1[j]; x1[j] = x2[j]; x2[j] = x3[j]; x3[j] = x4[j]; x4[j] = v[j]; }
                    if (i >= 2) { const int t = t0 + i - 2; float o[8];
#pragma unroll
                        for (int j = 0; j < 8; ++j) o[j] = siluf(bs[j] + wk[0][j] * x0[j] + wk[1][j] * x1[j] + wk[2][j] * x2[j] + wk[3][j] * x3[j] + wk[4][j] * x4[j]);
                        u32x4 w; w.x = pk2(o[0], o[1]); w.y = pk2(o[2], o[3]); w.z = pk2(o[4], o[5]); w.w = pk2(o[6], o[7]);
                        *(u32x4*)(XBC + (size_t)t * 2048 + c0) = w; }
                }
            }
        } else {
            const int ch = it - NCONV, tok0 = ch * 128;
            if (lane < 32) {
                const int h = lane & 15; const bool bw = lane >= 16;
                const float bias = bw ? a.in[7][h] : a.in[6][h];
                const float A = -__expf(bw ? a.in[9][h] : a.in[8][h]);
                float* DTo = bw ? DTB : DTF; float* ACo = bw ? ACB : ACF;
                float run = 0.f;
#pragma unroll 8
                for (int i = 0; i < 128; ++i) { const int tt = tok0 + (bw ? 127 - i : i);
                    const float raw = bf1(PROJ[(size_t)tt * NP + COL_DT + lane]) + bias;
                    const float dt = fmaxf(raw, 0.f) + log1pf(__expf(-fabsf(raw)));
                    run += dt * A; DTo[(size_t)tt * 16 + h] = dt; ACo[(size_t)tt * 16 + h] = run; }
            }
        }
    }
}

constexpr int P3_LDX = 264, P3_LDB = 72;
constexpr int P3_XW = 0, P3_BT = 128 * P3_LDX * 2, P3_WS = P3_BT + 128 * P3_LDB * 2, P3_DEC = P3_WS + 128 * 4 * 4;
__device__ __forceinline__ void p3_states(const Args& a, LAS unsigned char* lds, int bid, int G, int tid, int wave, int lane) {
    unsigned char* ws = a.ws;
    const bf16_t* XBC = (const bf16_t*)(ws + WS_XBC); bf16_t* PREV = (bf16_t*)(ws + WS_PREV);
    const float* DTF = (const float*)(ws + WS_DT);
    LAS bf16_t* XW = (LAS bf16_t*)(lds + P3_XW); LAS bf16_t* BT = (LAS bf16_t*)(lds + P3_BT); LAS float* WSC = (LAS float*)(lds + P3_WS); LAS float* DEC = (LAS float*)(lds + P3_DEC);
    for (int u = bid; u < NBATCH * 16; u += G) {
        const int b = u >> 4, g = (u >> 2) & 3, dir = (u >> 1) & 1, nh = u & 1;
        const float* DTd = DTF + (size_t)dir * T * 16; const float* ACd = DTF + (size_t)(2 + dir) * T * 16;
        f32x4 acc[2][4];
#pragma unroll
        for (int m = 0; m < 2; ++m)
#pragma unroll
            for (int n = 0; n < 4; ++n) acc[m][n] = (f32x4){0.f, 0.f, 0.f, 0.f};
        const int hw = wave >> 1;
        for (int cs = 0; cs < 16; ++cs) {
            const int c = dir ? 15 - cs : cs, tok0 = b * SEQ + c * 128, tend = dir ? tok0 : tok0 + 127;
            { const int s = tid >> 2, h = tid & 3; const float dt = DTd[(size_t)(tok0 + s) * 16 + g * 4 + h], ac = ACd[(size_t)(tok0 + s) * 16 + g * 4 + h], ae = ACd[(size_t)tend * 16 + g * 4 + h];
              WSC[s * 4 + h] = dt * fast_exp(ae - ac); if (s == 0) DEC[h] = fast_exp(ae); }
            __syncthreads();
#pragma unroll
            for (int i = 0; i < 8; ++i) { const int idx = tid + 512 * i, s = idx >> 5, ch = idx & 31; const float w = WSC[s * 4 + (ch >> 3)];
                float f[8]; unpack8(*(const u32x4*)(XBC + (size_t)(tok0 + s) * 2048 + g * 256 + ch * 8), f);
                u32x4 o; o.x = pk2(f[0] * w, f[1] * w); o.y = pk2(f[2] * w, f[3] * w); o.z = pk2(f[4] * w, f[5] * w); o.w = pk2(f[6] * w, f[7] * w);
                *(LAS u32x4*)(XW + s * P3_LDX + ch * 8) = o; }
#pragma unroll
            for (int i = 0; i < 2; ++i) { const int idx = tid + 512 * i, s = idx >> 3, ch = idx & 7;
                *(LAS u32x4*)(BT + s * P3_LDB + ch * 8) = *(const u32x4*)(XBC + (size_t)(tok0 + s) * 2048 + 1024 + g * 128 + nh * 64 + ch * 8); }
            { bf16_t* pv = PREV + ((size_t)((b * 16 + c) * 2 + dir) * 16 + g * 4) * 64 * 128;
#pragma unroll
              for (int m = 0; m < 2; ++m)
#pragma unroll
                  for (int n = 0; n < 4; ++n)
#pragma unroll
                      for (int r = 0; r < 4; ++r) { const int hp = 32 * wave + 16 * m + 4 * (lane >> 4) + r, nn = nh * 64 + 16 * n + (lane & 15);
                          pv[(size_t)hp * 128 + nn] = (bf16_t)f2bf(acc[m][n][r]); } }
            __syncthreads();
            const float dec = DEC[hw];
#pragma unroll
            for (int m = 0; m < 2; ++m)
#pragma unroll
                for (int n = 0; n < 4; ++n) acc[m][n] = acc[m][n] * dec;
#pragma unroll
            for (int ks = 0; ks < 4; ++ks) {
                bf16x8 af[2], bfr[4];
#pragma unroll
                for (int m = 0; m < 2; ++m) af[m] = frag_kcol(XW, P3_LDX, 32 * ks, 32 * wave + 16 * m, lane);
#pragma unroll
                for (int n = 0; n < 4; ++n) bfr[n] = frag_kcol(BT, P3_LDB, 32 * ks, 16 * n, lane);
#pragma unroll
                for (int m = 0; m < 2; ++m)
#pragma unroll
                    for (int n = 0; n < 4; ++n) acc[m][n] = MFMA16(af[m], bfr[n], acc[m][n]);
            }
            __syncthreads();
        }
    }
}

constexpr int P5_LD = 136, P5_LDH = 72;
constexpr int P5_CL = 0, P5_BL = P5_CL + 128 * P5_LD * 2, P5_ML = P5_BL + 128 * P5_LD * 2, P5_XL = P5_ML + 128 * P5_LD * 2, P5_ZL = P5_XL + 128 * P5_LDH * 2, P5_SM = P5_ZL + 128 * P5_LDH * 2, P5_END = P5_SM + 4 * 128 * 4 * 4;
static_assert(P5_END <= LDS_CTL_OFF, "P5 LDS");
__device__ __forceinline__ void p5_output(const Args& a, LAS unsigned char* lds, int bid, int G, int tid, int wave, int lane) {
    unsigned char* ws = a.ws;
    const bf16_t* XBC = (const bf16_t*)(ws + WS_XBC); const bf16_t* PREV = (const bf16_t*)(ws + WS_PREV); const bf16_t* PROJ = (const bf16_t*)(ws + WS_PROJ); bf16_t* Y = (bf16_t*)(ws + WS_Y);
    const float* DTF = (const float*)(ws + WS_DT);
    LAS bf16_t* CL = (LAS bf16_t*)(lds + P5_CL); LAS bf16_t* BL = (LAS bf16_t*)(lds + P5_BL); LAS bf16_t* PV = BL;
    LAS bf16_t* ML = (LAS bf16_t*)(lds + P5_ML) + wave * 16 * P5_LD; LAS bf16_t* XL = (LAS bf16_t*)(lds + P5_XL); LAS bf16_t* ZL = (LAS bf16_t*)(lds + P5_ZL);
    LAS float* SM = (LAS float*)(lds + P5_SM);
    const int li = lane & 15, gq = lane >> 4;
    for (int u = bid; u < NCHUNK * 4; u += G) {
        const int bc = u >> 2, g = u & 3, tok0 = bc * 128;
#pragma unroll
        for (int i = 0; i < 4; ++i) { const int idx = tid + 512 * i, s = idx >> 4, ch = idx & 15; const bf16_t* rp = XBC + (size_t)(tok0 + s) * 2048 + g * 128 + ch * 8;
            *(LAS u32x4*)(BL + s * P5_LD + ch * 8) = *(const u32x4*)(rp + 1024); *(LAS u32x4*)(CL + s * P5_LD + ch * 8) = *(const u32x4*)(rp + 1536); }
#pragma unroll
        for (int i = 0; i < 4; ++i) { const int s = tid >> 2, h = tid & 3; SM[(i * 128 + s) * 4 + h] = DTF[(size_t)i * T * 16 + (size_t)(tok0 + s) * 16 + g * 4 + h]; }
        __syncthreads();
        f32x4 cb[8];
#pragma unroll
        for (int n = 0; n < 8; ++n) cb[n] = (f32x4){0.f, 0.f, 0.f, 0.f};
#pragma unroll
        for (int ks = 0; ks < 4; ++ks) { const bf16x8 af = frag_rowk(CL, P5_LD, 16 * wave, 32 * ks, lane);
#pragma unroll
            for (int n = 0; n < 8; ++n) cb[n] = MFMA16(af, frag_rowk(BL, P5_LD, 16 * n, 32 * ks, lane), cb[n]); }
        __syncthreads();
        float ssq[4] = {0.f, 0.f, 0.f, 0.f};
#pragma unroll 1
        for (int hh = 0; hh < 4; ++hh) {
            const int h16 = g * 4 + hh;
#pragma unroll
            for (int i = 0; i < 2; ++i) { const int idx = tid + 512 * i, s = idx >> 3, ch = idx & 7;
                *(LAS u32x4*)(XL + s * P5_LDH + ch * 8) = *(const u32x4*)(XBC + (size_t)(tok0 + s) * 2048 + h16 * 64 + ch * 8);
                *(LAS u32x4*)(ZL + s * P5_LDH + ch * 8) = *(const u32x4*)(PROJ + (size_t)(tok0 + s) * NP + COL_Z + h16 * 64 + ch * 8); }
#pragma unroll
            for (int i = 0; i < 4; ++i) { const int idx = tid + 512 * i, dp = idx >> 4, ch = idx & 15, dir = dp >> 6, p = dp & 63;
                *(LAS u32x4*)(PV + dp * P5_LD + ch * 8) = *(const u32x4*)(PREV + (((size_t)(bc * 2 + dir) * 16 + h16) * 64 + p) * 128 + ch * 8); }
            float el_f[4], el_b[4];
#pragma unroll
            for (int r = 0; r < 4; ++r) { const int l = 16 * wave + 4 * gq + r; el_f[r] = SM[(2 * 128 + l) * 4 + hh]; el_b[r] = SM[(3 * 128 + l) * 4 + hh]; }
#pragma unroll
            for (int n = 0; n < 8; ++n) { const int s = 16 * n + li; const float dtf = SM[(0 * 128 + s) * 4 + hh], dtb = SM[(1 * 128 + s) * 4 + hh], af_s = SM[(2 * 128 + s) * 4 + hh], ab_s = SM[(3 * 128 + s) * 4 + hh];
#pragma unroll
                for (int r = 0; r < 4; ++r) { const int l = 16 * wave + 4 * gq + r;
                    const float ff = (s <= l) ? dtf * fast_exp(el_f[r] - af_s) : 0.f, fb = (s >= l) ? dtb * fast_exp(el_b[r] - ab_s) : 0.f;
                    ML[(4 * gq + r) * P5_LD + s] = (bf16_t)f2bf(cb[n][r] * (ff + fb)); } }
            __syncthreads();
            f32x4 yd[4], yf[4], yb[4];
#pragma unroll
            for (int n = 0; n < 4; ++n) { yd[n] = (f32x4){0.f, 0.f, 0.f, 0.f}; yf[n] = yd[n]; yb[n] = yd[n]; }
#pragma unroll
            for (int ks = 0; ks < 4; ++ks) { const bf16x8 am = frag_rowk(ML, P5_LD, 0, 32 * ks, lane), ac_ = frag_rowk(CL, P5_LD, 16 * wave, 32 * ks, lane);
#pragma unroll
                for (int n = 0; n < 4; ++n) { yd[n] = MFMA16(am, frag_kcol(XL, P5_LDH, 32 * ks, 16 * n, lane), yd[n]);
                    yf[n] = MFMA16(ac_, frag_rowk(PV, P5_LD, 16 * n, 32 * ks, lane), yf[n]);
                    yb[n] = MFMA16(ac_, frag_rowk(PV + 64 * P5_LD, P5_LD, 16 * n, 32 * ks, lane), yb[n]); } }
            const float dsk = a.in[10][h16];
#pragma unroll
            for (int r = 0; r < 4; ++r) { const int l = 16 * wave + 4 * gq + r; const float ef = fast_exp(el_f[r]), eb = fast_exp(el_b[r]);
#pragma unroll
                for (int n = 0; n < 4; ++n) { const int p = 16 * n + li; const float xs = bf1(XL[l * P5_LDH + p]), z = bf1(ZL[l * P5_LDH + p]);
                    const float val = (yd[n][r] + ef * yf[n][r] + eb * yb[n][r] + dsk * xs) * siluf(z);
                    const unsigned vb = f2bf(val); const float vr = __builtin_bit_cast(float, vb << 16);
                    ssq[r] += vr * vr; Y[(size_t)(tok0 + l) * 2048 + 1024 + h16 * 64 + p] = (bf16_t)vb; } }
            __syncthreads();
        }
        VM_WAIT();
#pragma unroll
        for (int r = 0; r < 4; ++r) { float s = ssq[r];
            s += __shfl_xor(s, 1); s += __shfl_xor(s, 2); s += __shfl_xor(s, 4); s += __shfl_xor(s, 8);
            const float rstd = __builtin_amdgcn_rsqf(s * (1.f / 256.f) + EPS);
            const int l = 16 * wave + 4 * gq + r; bf16_t* yp = Y + (size_t)(tok0 + l) * 2048 + 1024 + g * 256 + li; const float* nw = a.in[11] + g * 256 + li;
#pragma unroll
            for (int n = 0; n < 16; ++n) yp[16 * n] = (bf16_t)f2bf(bf1(yp[16 * n]) * rstd * nw[16 * n]); }
    }
}

__device__ __forceinline__ void p9_topk(const Args& a, LAS unsigned char* lds, int bid, int G, int tid) {
    unsigned char* ws = a.ws;
    const float* LOG = (const float*)(ws + WS_LOG); int* TOPI = (int*)(ws + WS_TOPI); float* TOPG = (float*)(ws + WS_TOPG); int* TOPP = (int*)(ws + WS_TOPP);
    unsigned* gcount = (unsigned*)(ws + WS_CTL) + CW_GCOUNT;
    LAS unsigned* hist = (LAS unsigned*)lds; LAS unsigned* base = hist + 32;
    for (int t0 = bid * 512; t0 < T; t0 += G * 512) {
        if (tid < 32) hist[tid] = 0u;
        __syncthreads();
        const int t = t0 + tid;
        float l[32];
        { const f32x4* lp = (const f32x4*)(LOG + (size_t)t * 32); const f32x4* bp = (const f32x4*)a.in[15];
#pragma unroll
          for (int j = 0; j < 8; ++j) { const f32x4 v = lp[j] + bp[j]; l[4 * j] = v.x; l[4 * j + 1] = v.y; l[4 * j + 2] = v.z; l[4 * j + 3] = v.w; } }
        int bi[4]; float bv[4];
#pragma unroll
        for (int k = 0; k < 4; ++k) { float best = -3.0e38f; int idx = 0;
#pragma unroll
            for (int i = 0; i < 32; ++i) { if (l[i] > best) { best = l[i]; idx = i; } }
            bi[k] = idx; bv[k] = best;
#pragma unroll
            for (int i = 0; i < 32; ++i) l[i] = (i == idx) ? -3.0e38f : l[i]; }
        float ev[4], es = 0.f;
#pragma unroll
        for (int k = 0; k < 4; ++k) { ev[k] = __expf(bv[k] - bv[0]); es += ev[k]; }
        const float inv = 1.0f / es;
        unsigned rk[4];
#pragma unroll
        for (int k = 0; k < 4; ++k) rk[k] = __hip_atomic_fetch_add(hist + bi[k], 1u, __ATOMIC_RELAXED, __HIP_MEMORY_SCOPE_WORKGROUP);
        __syncthreads();
        if (tid < 32) base[tid] = __hip_atomic_fetch_add(gcount + tid, hist[tid], __ATOMIC_RELAXED, __HIP_MEMORY_SCOPE_AGENT);
        __syncthreads();
#pragma unroll
        for (int k = 0; k < 4; ++k) { TOPI[(size_t)t * 4 + k] = bi[k]; TOPG[(size_t)t * 4 + k] = ev[k] * inv; TOPP[(size_t)t * 4 + k] = (int)(base[bi[k]] + rk[k]); }
        __syncthreads();
    }
}
__device__ __forceinline__ void p10_rows(const Args& a, LAS unsigned char* lds, int bid, int G, int tid) {
    unsigned char* ws = a.ws;
    const int* TOPI = (const int*)(ws + WS_TOPI); const float* TOPG = (const float*)(ws + WS_TOPG); const int* TOPP = (const int*)(ws + WS_TOPP);
    int* INV = (int*)(ws + WS_INV); int* ROWTOK = (int*)(ws + WS_ROWTOK); float* ROWGATE = (float*)(ws + WS_ROWGATE);
    unsigned* ctl = (unsigned*)(ws + WS_CTL);
    LAS unsigned* pstart = (LAS unsigned*)lds; LAS unsigned* pcnt = pstart + 64;
    if (tid == 0) { unsigned run = 0u;
        for (int e = 0; e < NE; ++e) { const unsigned c = ld_agent(ctl + CW_GCOUNT + e); pstart[e] = run; pcnt[e] = c; run += (c + 255u) & ~255u; }
        pstart[32] = run; }
    __syncthreads();
    for (int t = bid * 512 + tid; t < T; t += G * 512) {
#pragma unroll
        for (int k = 0; k < 4; ++k) { const int e = TOPI[(size_t)t * 4 + k]; const int row = (int)pstart[e] + TOPP[(size_t)t * 4 + k];
            ROWTOK[row] = t; ROWGATE[row] = TOPG[(size_t)t * 4 + k]; INV[(size_t)t * 4 + k] = row; }
    }
    for (int e = bid; e < NE; e += G) { const unsigned s0 = pstart[e] + pcnt[e], s1 = pstart[e] + ((pcnt[e] + 255u) & ~255u);
        for (unsigned r = s0 + tid; r < s1; r += 512) { ROWTOK[r] = 0; ROWGATE[r] = 0.f; }
        for (unsigned tl = pstart[e] / 256 + tid; tl < s1 / 256; tl += 512) ctl[CW_TILEE + tl] = (unsigned)e; }
    if (bid == 0 && tid == 0) ctl[CW_NT] = pstart[32] / 256;
}
__device__ __forceinline__ void p13_final(const Args& a, int gw, int NGW, int lane, bool with_moe) {
    unsigned char* ws = a.ws;
    const float* X1 = (const float*)(ws + WS_X1); const bf16_t* YS = (const bf16_t*)(ws + WS_YSLOT); const int* INV = (const int*)(ws + WS_INV);
    for (int t = gw; t < T; t += NGW) {
        float v[4][8]; float ss = 0.f;
#pragma unroll
        for (int j = 0; j < 4; ++j) { const f32x4* xp = (const f32x4*)(X1 + (size_t)t * D + 8 * (lane + 64 * j)); const f32x4 x0 = xp[0], x1 = xp[1];
            v[j][0] = x0.x; v[j][1] = x0.y; v[j][2] = x0.z; v[j][3] = x0.w; v[j][4] = x1.x; v[j][5] = x1.y; v[j][6] = x1.z; v[j][7] = x1.w; }
        if (with_moe) {
#pragma unroll
            for (int k = 0; k < 4; ++k) { const int row = INV[(size_t)t * 4 + k];
#pragma unroll
                for (int j = 0; j < 4; ++j) { float f[8]; unpack8(*(const u32x4*)(YS + (size_t)row * D + 8 * (lane + 64 * j)), f);
#pragma unroll
                    for (int q = 0; q < 8; ++q) v[j][q] += f[q]; } }
        }
#pragma unroll
        for (int j = 0; j < 4; ++j)
#pragma unroll
            for (int q = 0; q < 8; ++q) ss += v[j][q] * v[j][q];
        const float rstd = __builtin_amdgcn_rsqf(wave_sum(ss) * (1.f / D) + EPS);
#pragma unroll
        for (int j = 0; j < 4; ++j) { const f32x4* wp = (const f32x4*)(a.in[20] + 8 * (lane + 64 * j)); const f32x4 w0 = wp[0], w1 = wp[1];
            f32x4* op = (f32x4*)(a.out + (size_t)t * D + 8 * (lane + 64 * j));
            op[0] = (f32x4){v[j][0] * rstd * w0.x, v[j][1] * rstd * w0.y, v[j][2] * rstd * w0.z, v[j][3] * rstd * w0.w};
            op[1] = (f32x4){v[j][4] * rstd * w1.x, v[j][5] * rstd * w1.y, v[j][6] * rstd * w1.z, v[j][7] * rstd * w1.w}; }
    }
}

constexpr int N_PHASES = 14;
__global__ void __launch_bounds__(512, 2) mk_fwd(Args args) {
    extern __shared__ __attribute__((aligned(16))) unsigned char lds_raw[];
    LAS unsigned char* lds = (LAS unsigned char*)lds_raw;
    const int tid = threadIdx.x, lane = tid & 63, wave = __builtin_amdgcn_readfirstlane(tid >> 6);
    const int G = gridDim.x, bid = blockIdx.x;
    const int gw = bid * 8 + wave, NGW = G * 8;
    unsigned char* ws = args.ws;
    unsigned* ctl = (unsigned*)(ws + WS_CTL);
    volatile LAS unsigned* MISC = (volatile LAS unsigned*)(lds + LDS_CTL_OFF);
    for (int u = tid; u < (LDS_BYTES - LDS_CTL_OFF) / 4; u += 512) ((LAS unsigned*)(lds + LDS_CTL_OFF))[u] = 0u;
    __syncthreads();
    const int lo = args.ph_lo, hi = args.ph_hi;
    XcdBarrier bar; bar.bar = ctl + CW_BAR; bar.x = 0; bar.st = nullptr;
    if (hi - lo > 1) bar = xcd_barrier_post(ctl + CW_BAR, MISC + 8);
#ifdef MK_ONLY
#define IN(k) ((k) == MK_ONLY && lo <= (k) && (k) < hi)
#else
#define IN(k) (lo <= (k) && (k) < hi)
#endif
#define SEAM(k) do { if (IN(k) && IN((k) + 1)) xcd_barrier(bar); } while (0)

    if (IN(0)) { p0_prologue(args, lds, gw, NGW, wave, lane); }
    SEAM(0);
    if (IN(1)) { pg8::SchedPlain S; S.init(T / 256, NP / 256, G, bid); pg8::EpiProj E{(bf16_t*)(ws + WS_PROJ), NP};
        pg8::gemm_phase(lds, (const char*)(ws + WS_H), (const char*)(ws + WS_WIN), D, S, E); }
    SEAM(1);
    if (IN(2)) { p2_conv(args, gw, NGW, lane); }
    SEAM(2);
    if (IN(3)) { if (MK_LAST_PHASE >= 3) p3_states(args, lds, bid, G, tid, wave, lane); }
    SEAM(3);
    SEAM(4);
    if (IN(5)) { if (MK_LAST_PHASE >= 5) p5_output(args, lds, bid, G, tid, wave, lane);
        else { bf16_t* Y = (bf16_t*)(ws + WS_Y); for (size_t i = (size_t)bid * 512 + tid; i < (size_t)T * 1024 / 8; i += (size_t)G * 512) { const size_t t = i / 128, c = i % 128; *(u32x4*)(Y + t * 2048 + 1024 + c * 8) = (u32x4){0u, 0u, 0u, 0u}; } } }
    SEAM(5);
    if (IN(6)) { pg8::SchedPlain S; S.init(T / 256, D / 256, G, bid); pg8::EpiRes E{args.in[0], (float*)(ws + WS_X1)};
        pg8::gemm_phase(lds, (const char*)(ws + WS_Y), (const char*)(ws + WS_WOUT), 2048, S, E); }
    SEAM(6);
    if (IN(7)) { if (MK_LAST_PHASE >= 7) { const float* X1 = (const float*)(ws + WS_X1); bf16_t* H = (bf16_t*)(ws + WS_H);
        for (int m = gw; m < T; m += NGW) rmsnorm_row_bf16(X1 + (size_t)m * D, args.in[13], H + (size_t)m * D, lane); } }
    SEAM(7);
    if (IN(8)) { if (MK_LAST_PHASE >= 7) { pg8::SchedPlain S; S.init(T / 256, 1, G, bid); pg8::EpiLogits E{(float*)(ws + WS_LOG)};
        pg8::gemm_phase(lds, (const char*)(ws + WS_H), (const char*)(ws + WS_WR), D, S, E); } }
    SEAM(8);
    if (IN(9)) { if (MK_LAST_PHASE >= 7) p9_topk(args, lds, bid, G, tid); }
    SEAM(9);
    if (IN(10)) { if (MK_LAST_PHASE >= 7) p10_rows(args, lds, bid, G, tid); }
    SEAM(10);
    if (IN(11)) { if (MK_LAST_PHASE >= 7) { const int ntile = (int)ld_agent(ctl + CW_NT);
        pg8::SchedUp S; S.init(ntile, 16, G, bid); S.row_tok = (const int*)(ws + WS_ROWTOK); S.tile_e = ctl + CW_TILEE;
        pg8::EpiSwiglu E{(bf16_t*)(ws + WS_ACT), args.in[17], ctl + CW_TILEE};
        pg8::gemm_phase(lds, (const char*)(ws + WS_H), (const char*)(ws + WS_WGU), D, S, E); } }
    SEAM(11);
    if (IN(12)) { if (MK_LAST_PHASE >= 7) { const int ntile = (int)ld_agent(ctl + CW_NT);
        pg8::SchedDown S; S.init(ntile, 8, G, bid); S.tile_e = ctl + CW_TILEE;
        pg8::EpiDown E{(bf16_t*)(ws + WS_YSLOT), args.in[19], (const float*)(ws + WS_ROWGATE), ctl + CW_TILEE};
        pg8::gemm_phase(lds, (const char*)(ws + WS_ACT), (const char*)(ws + WS_WDN), DFF, S, E); } }
    SEAM(12);
    if (IN(13)) { p13_final(args, gw, NGW, lane, MK_LAST_PHASE >= 7); }
#undef IN
#undef SEAM
}

extern "C" void kernel_launch(void* const* d_in, const int* in_sizes, int n_in, void* d_out, int out_size, void* d_ws, size_t ws_size, hipStream_t stream) {
    static int grid = 0;
    if (grid == 0) {
        if (n_in != 21 || out_size != T * D || ws_size < WS_END) { fprintf(stderr, "kernel_launch: unexpected shapes (n_in %d out %d ws %zu need %zu)\n", n_in, out_size, ws_size, (size_t)WS_END); grid = -1; return; }
        int dev = 0, cus = 0, per_cu = 0;
        if (hipGetDevice(&dev) != hipSuccess || hipDeviceGetAttribute(&cus, hipDeviceAttributeMultiprocessorCount, dev) != hipSuccess) { grid = -1; return; }
        if (hipFuncSetAttribute((const void*)mk_fwd, hipFuncAttributeMaxDynamicSharedMemorySize, LDS_BYTES) != hipSuccess) { fprintf(stderr, "kernel_launch: hipFuncSetAttribute failed\n"); grid = -1; return; }
        if (hipOccupancyMaxActiveBlocksPerMultiprocessor(&per_cu, (const void*)mk_fwd, 512, LDS_BYTES) != hipSuccess || per_cu < 1) { fprintf(stderr, "kernel_launch: occupancy query says %d\n", per_cu); }
        (void)hipGetLastError();
        grid = cus;
    }
    if (grid < 0) return;
    (void)in_sizes;
    if (hipMemsetAsync((char*)d_ws + WS_CTL, 0, CTL_ZERO_BYTES, stream) != hipSuccess) return;
    Args a{};
    for (int i = 0; i < 21; ++i) a.in[i] = (const float*)d_in[i];
    a.out = (float*)d_out; a.ws = (unsigned char*)d_ws;
#if MK_N_LAUNCHES == 1
    a.ph_lo = 0; a.ph_hi = N_PHASES;
    hipLaunchKernelGGL(mk_fwd, dim3(grid), dim3(512), LDS_BYTES, stream, a);
#else
    for (int p = 0; p < N_PHASES; ++p) { if (p == 4) continue; a.ph_lo = p; a.ph_hi = p + 1; hipLaunchKernelGGL(mk_fwd, dim3(grid), dim3(512), LDS_BYTES, stream, a); }
#endif
}
```
